# Optimizing an MI355X kernel written in HIP

```python
import math
import jax, jax.numpy as jnp
from jax import lax
import numpy as np

D_MODEL = 1024
BATCH = 2
SEQ = 8192
DEPTH = 2

DA_HEADS = 4
DA_QK_DIM = 64
DA_V_DIM = 2 * DA_QK_DIM
DA_ROT_DIM = DA_QK_DIM // 4
ROPE_THETA = 500000.0
Q_BLOCK = 128
RET_HEADS = 4
RET_QK_DIM = 32
RET_V_DIM = 2 * RET_QK_DIM
RET_THETA = 10000.0
RET_CHUNK = 128
POOL_GROUPS = 4
POOL_DIM = 64
POOL_WINDOWS = (2, 4, 8, 16)
DA_WIDTH = DA_HEADS * DA_V_DIM
RET_WIDTH = RET_HEADS * RET_V_DIM
POOL_WIDTH = POOL_GROUPS * POOL_DIM
MIX_WIDTH = DA_WIDTH + RET_WIDTH + POOL_WIDTH
SPLIT_SIZES = (DA_HEADS * 2 * DA_QK_DIM, DA_HEADS * 2 * DA_QK_DIM, DA_WIDTH,
               RET_HEADS * RET_QK_DIM, RET_HEADS * RET_QK_DIM, RET_WIDTH, RET_WIDTH,
               POOL_WIDTH)
IN_WIDTH = 2560
D_FF = 2816
CONV_WIDTH = 3
EPS = 1e-6

kernel_name = "hymba_style_diffattn_retention_pool_hybrid"


def rms_norm(x, g):
    xf = x.astype(jnp.float32)
    y = xf * lax.rsqrt(jnp.mean(xf * xf, axis=-1, keepdims=True) + EPS)
    return (y * g).astype(x.dtype)


def rotary(x, pos, rot_dim, theta):
    inv = jnp.float32(theta) ** (-jnp.arange(0, rot_dim, 2, dtype=jnp.float32) / rot_dim)
    ang = pos[:, None] * inv[None, :]
    cos = jnp.cos(ang).astype(x.dtype)
    sin = jnp.sin(ang).astype(x.dtype)
    half = rot_dim // 2
    x1, x2, xp = x[..., :half], x[..., half:rot_dim], x[..., rot_dim:]
    return jnp.concatenate([x1 * cos - x2 * sin, x2 * cos + x1 * sin, xp], axis=-1)


def diff_attention(q, k, v, lq1, lk1, lq2, lk2, subln_g, lam_init):
    B, S, _ = q.shape
    pos = jnp.arange(S, dtype=jnp.float32)
    q = q.reshape(B, S, DA_HEADS, 2, DA_QK_DIM).transpose(0, 2, 3, 1, 4)
    k = k.reshape(B, S, DA_HEADS, 2, DA_QK_DIM).transpose(0, 2, 3, 1, 4)
    q = rotary(q, pos, DA_ROT_DIM, ROPE_THETA)
    k = rotary(k, pos, DA_ROT_DIM, ROPE_THETA)
    v = v.reshape(B, S, DA_HEADS, DA_V_DIM).transpose(0, 2, 1, 3)
    lam = (jnp.exp(jnp.sum(lq1.astype(jnp.float32) * lk1.astype(jnp.float32)))
           - jnp.exp(jnp.sum(lq2.astype(jnp.float32) * lk2.astype(jnp.float32))) + lam_init)
    scale = DA_QK_DIM ** -0.5
    nb = S // Q_BLOCK
    qb = q.reshape(B, DA_HEADS, 2, nb, Q_BLOCK, DA_QK_DIM).transpose(3, 0, 1, 2, 4, 5)
    kpos = jnp.arange(S)

    def block(args):
        q_blk, i = args
        s = jnp.einsum('bhmqd,bhmkd->bhmqk', q_blk, k).astype(jnp.float32) * scale
        qpos = i * Q_BLOCK + jnp.arange(Q_BLOCK)
        mask = kpos[None, :] <= qpos[:, None]
        p = jax.nn.softmax(jnp.where(mask, s, -jnp.inf), axis=-1)
        a = p[:, :, 0] - lam * p[:, :, 1]
        return jnp.einsum('bhqk,bhkd->bhqd', a.astype(v.dtype), v)

    o = lax.map(block, (qb, jnp.arange(nb)))
    o = o.transpose(1, 0, 3, 2, 4).reshape(B, S, DA_HEADS, DA_V_DIM)
    o = rms_norm(o, subln_g) * (1.0 - lam_init)
    return o.reshape(B, S, DA_WIDTH)


def retention(q, k, v, g, ret_g):
    B, S, _ = q.shape
    H, dk, dv, C = RET_HEADS, RET_QK_DIM, RET_V_DIM, RET_CHUNK
    pos = jnp.arange(S, dtype=jnp.float32)
    q = rotary(q.reshape(B, S, H, dk).transpose(0, 2, 1, 3), pos, dk, RET_THETA)
    k = rotary(k.reshape(B, S, H, dk).transpose(0, 2, 1, 3), pos, dk, RET_THETA) * (dk ** -0.5)
    v = v.reshape(B, S, H, dv).transpose(0, 2, 1, 3)
    log_g = jnp.log(1.0 - 2.0 ** (-5.0 - jnp.arange(H, dtype=jnp.float32)))
    idx = jnp.arange(C, dtype=jnp.float32)
    diff = idx[:, None] - idx[None, :]
    decay = jnp.where(diff >= 0, jnp.exp(jnp.maximum(diff, 0.0) * log_g[:, None, None]), 0.0)
    xi = jnp.exp((idx + 1.0) * log_g[:, None])[..., None]
    zeta = jnp.exp((C - 1.0 - idx) * log_g[:, None])[..., None]
    chunk_decay = jnp.exp(C * log_g)[:, None, None]
    nc = S // C

    def to_chunks(t):
        return t.reshape(B, H, nc, C, t.shape[-1]).transpose(2, 0, 1, 3, 4).astype(jnp.float32)

    def step(state, inp):
        qi, ki, vi = inp
        inner = jnp.einsum('bhqd,bhkd->bhqk', qi, ki) * decay
        o = (jnp.einsum('bhqk,bhkv->bhqv', inner, vi)
             + jnp.einsum('bhqd,bhdv->bhqv', qi * xi, state))
        state = state * chunk_decay + jnp.einsum('bhkd,bhkv->bhdv', ki * zeta, vi)
        return state, o

    state0 = jnp.zeros((B, H, dk, dv), jnp.float32)
    _, o = lax.scan(step, state0, (to_chunks(q), to_chunks(k), to_chunks(v)))
    o = o.transpose(1, 0, 3, 2, 4).reshape(B, S, H, dv)
    mu = jnp.mean(o, axis=-1, keepdims=True)
    var = jnp.mean(jnp.square(o - mu), axis=-1, keepdims=True)
    o = (o - mu) * lax.rsqrt(var + EPS) * ret_g.reshape(H, dv)
    return jax.nn.silu(g) * o.reshape(B, S, RET_WIDTH).astype(g.dtype)


def pool_mixer(u, pool_w, pool_scale):
    B, S, _ = u.shape
    ug = u.reshape(B, S, POOL_GROUPS, POOL_DIM).astype(jnp.float32)
    c = jnp.cumsum(ug, axis=1)
    t = jnp.arange(S, dtype=jnp.float32)
    means = []
    for gi, w in enumerate(POOL_WINDOWS):
        cg = c[:, :, gi]
        shifted = jnp.pad(cg, ((0, 0), (w, 0), (0, 0)))[:, :S]
        means.append((cg - shifted) / jnp.minimum(t + 1.0, float(w))[:, None])
    pooled = (jnp.stack(means, axis=2) - ug).astype(u.dtype)
    y = jnp.einsum('bsgp,gpq->bsgq', pooled, pool_w)
    return y.reshape(B, S, POOL_WIDTH) * pool_scale


def conv_mlp(h, w_up, conv_w, conv_b, w_down):
    S = h.shape[1]
    u = h @ w_up
    up = jnp.pad(u, ((0, 0), (CONV_WIDTH - 1, 0), (0, 0)))
    uc = conv_b + sum(conv_w[j] * up[:, j:j + S] for j in range(CONV_WIDTH))
    gate, val = jnp.split(uc, 2, axis=-1)
    return (jax.nn.gelu(gate, approximate=True) * val) @ w_down


def setup_inputs(seed: int = 0) -> dict:
    key = jax.random.key(seed)
    ks = jax.random.split(key, 24)
    f32 = jnp.float32

    def nrm(k, shape, scale):
        return jax.random.normal(k, shape, f32) * scale

    def gain(k, shape):
        return 1.0 + 0.05 * jax.random.normal(k, shape, f32)

    L = DEPTH
    return {
        "x": nrm(ks[0], (BATCH, SEQ, D_MODEL), 1.0),
        "norm_mix_pre": gain(ks[1], (L, D_MODEL)),
        "norm_mix_post": gain(ks[2], (L, D_MODEL)),
        "w_in": nrm(ks[3], (L, D_MODEL, IN_WIDTH), D_MODEL ** -0.5),
        "lambda_q1": nrm(ks[4], (L, DA_QK_DIM), 0.1),
        "lambda_k1": nrm(ks[5], (L, DA_QK_DIM), 0.1),
        "lambda_q2": nrm(ks[6], (L, DA_QK_DIM), 0.1),
        "lambda_k2": nrm(ks[7], (L, DA_QK_DIM), 0.1),
        "diff_subln": gain(ks[8], (L, DA_V_DIM)),
        "ret_norm": gain(ks[9], (L, RET_WIDTH)),
        "pool_w": nrm(ks[10], (L, POOL_GROUPS, POOL_DIM, POOL_DIM), POOL_DIM ** -0.5),
        "pool_scale": 0.5 + 0.1 * jax.random.normal(ks[11], (L, POOL_WIDTH), f32),
        "w_out": nrm(ks[12], (L, MIX_WIDTH, D_MODEL), MIX_WIDTH ** -0.5),
        "norm_mlp_pre": gain(ks[13], (L, D_MODEL)),
        "norm_mlp_post": gain(ks[14], (L, D_MODEL)),
        "w_up": nrm(ks[15], (L, D_MODEL, 2 * D_FF), D_MODEL ** -0.5),
        "conv_w": nrm(ks[16], (L, CONV_WIDTH, 2 * D_FF), CONV_WIDTH ** -0.5),
        "conv_b": nrm(ks[17], (L, 2 * D_FF), 0.02),
        "w_down": nrm(ks[18], (L, D_FF, D_MODEL), D_FF ** -0.5),
    }


def reference(x, norm_mix_pre, norm_mix_post, w_in, lambda_q1, lambda_k1, lambda_q2, lambda_k2,
              diff_subln, ret_norm, pool_w, pool_scale, w_out, norm_mlp_pre, norm_mlp_post,
              w_up, conv_w, conv_b, w_down):
    split_points = []
    acc = 0
    for s in SPLIT_SIZES[:-1]:
        acc += s
        split_points.append(acc)
    for l in range(DEPTH):
        lam_init = 0.8 - 0.6 * math.exp(-0.3 * l)
        h = rms_norm(x, norm_mix_pre[l])
        proj = h @ w_in[l]
        q_da, k_da, v_da, q_r, k_r, v_r, g_r, u_pool = jnp.split(proj, split_points, axis=-1)
        o_da = diff_attention(q_da, k_da, v_da, lambda_q1[l], lambda_k1[l], lambda_q2[l],
                              lambda_k2[l], diff_subln[l], lam_init)
        o_ret = retention(q_r, k_r, v_r, g_r, ret_norm[l])
        o_pool = pool_mixer(u_pool, pool_w[l], pool_scale[l])
        mix = jnp.concatenate([o_da, o_ret, o_pool], axis=-1) @ w_out[l]
        x = x + rms_norm(mix, norm_mix_post[l])
        h = rms_norm(x, norm_mlp_pre[l])
        y = conv_mlp(h, w_up[l], conv_w[l], conv_b[l], w_down[l])
        x = x + rms_norm(y, norm_mlp_post[l])
    return x
```

```cpp
#include <hip/hip_runtime.h>
#include <cstdint>
#include <cmath>

typedef unsigned short bf16_t;
__device__ __forceinline__ float bf2f(bf16_t v) { return __uint_as_float(((unsigned)v) << 16); }
__device__ __forceinline__ bf16_t f2bf(float f) { unsigned u = __float_as_uint(f); return (bf16_t)((u + 0x7fffu + ((u >> 16) & 1u)) >> 16); }

constexpr int BATCH = 2, SEQ = 8192, D = 1024, M = BATCH * SEQ, DEPTH = 2;
constexpr int INW = 2560, FF = 2816, UPW = 2 * FF;
constexpr float EPS = 1e-6f;
constexpr float C2 = 0.125f * 1.4426950408889634f;
constexpr size_t MiB = 1u << 20;

struct RotTab { float da[8]; float rt[16]; };

__device__ __forceinline__ float wave_sum(float v) {
#pragma unroll
    for (int o = 1; o < 64; o <<= 1) v += __shfl_xor(v, o);
    return v;
}
__device__ __forceinline__ void sincos_acc(float ang, float& s, float& c) {
    const double rev = (double)ang * 0.15915494309189533577;
    const double fr = rev - rint(rev);
    const float f = (float)fr;
    s = __builtin_amdgcn_sinf(f); c = __builtin_amdgcn_cosf(f);
}

__global__ void __launch_bounds__(256) k_rmsnorm(const float* __restrict__ x, const float* __restrict__ g, bf16_t* __restrict__ out) {
    const int row = blockIdx.x * 4 + (threadIdx.x >> 6), lane = threadIdx.x & 63;
    const float* xr = x + (size_t)row * D; float v[16]; float s = 0.f;
#pragma unroll
    for (int j = 0; j < 16; ++j) { v[j] = xr[lane + 64 * j]; s += v[j] * v[j]; }
    const float r = 1.0f / sqrtf(wave_sum(s) * (1.f / D) + EPS);
#pragma unroll
    for (int j = 0; j < 16; ++j) out[(size_t)row * D + lane + 64 * j] = f2bf(v[j] * r * g[lane + 64 * j]);
}
__global__ void __launch_bounds__(256) k_postnorm(const bf16_t* __restrict__ Y, const float* __restrict__ g, const float* __restrict__ Xin, float* __restrict__ X) {
    const int row = blockIdx.x * 4 + (threadIdx.x >> 6), lane = threadIdx.x & 63;
    float v[16]; float s = 0.f;
#pragma unroll
    for (int j = 0; j < 16; ++j) { v[j] = bf2f(Y[(size_t)row * D + lane + 64 * j]); s += v[j] * v[j]; }
    const float r = 1.0f / sqrtf(wave_sum(s) * (1.f / D) + EPS);
#pragma unroll
    for (int j = 0; j < 16; ++j) { const size_t o = (size_t)row * D + lane + 64 * j; X[o] = Xin[o] + v[j] * r * g[lane + 64 * j]; }
}

__global__ void __launch_bounds__(256) k_gemm(const bf16_t* __restrict__ A, int lda, const float* __restrict__ B, int ldb, bf16_t* __restrict__ C, int ldc, int Mrows, int K) {
    __shared__ float As[16][68]; __shared__ float Bs[16][68];
    const int tx = threadIdx.x & 15, ty = threadIdx.x >> 4; const int m0 = blockIdx.y * 64, n0 = blockIdx.x * 64;
    float acc[4][4];
#pragma unroll
    for (int i = 0; i < 4; ++i)
#pragma unroll
        for (int j = 0; j < 4; ++j) acc[i][j] = 0.f;
    for (int k0 = 0; k0 < K; k0 += 16) {
#pragma unroll
        for (int i = 0; i < 4; ++i) { const int idx = threadIdx.x + i * 256; const int r = idx >> 4, c = idx & 15; const int gr = m0 + r; As[c][r] = gr < Mrows ? bf2f(A[(size_t)gr * lda + k0 + c]) : 0.f; }
#pragma unroll
        for (int i = 0; i < 4; ++i) { const int idx = threadIdx.x + i * 256; const int r = idx >> 6, c = idx & 63; Bs[r][c] = B[(size_t)(k0 + r) * ldb + n0 + c]; }
        __syncthreads();
#pragma unroll
        for (int kk = 0; kk < 16; ++kk) { float a[4], b[4];
#pragma unroll
            for (int i = 0; i < 4; ++i) { a[i] = As[kk][ty * 4 + i]; b[i] = Bs[kk][tx * 4 + i]; }
#pragma unroll
            for (int i = 0; i < 4; ++i)
#pragma unroll
                for (int j = 0; j < 4; ++j) acc[i][j] += a[i] * b[j]; }
        __syncthreads();
    }
#pragma unroll
    for (int i = 0; i < 4; ++i) { const int gr = m0 + ty * 4 + i; if (gr < Mrows) {
#pragma unroll
        for (int j = 0; j < 4; ++j) C[(size_t)gr * ldc + n0 + tx * 4 + j] = f2bf(acc[i][j]); } }
}

__global__ void __launch_bounds__(256) k_rotary(bf16_t* __restrict__ P, RotTab tab) {
    const size_t gid = (size_t)blockIdx.x * 256 + threadIdx.x; const int row = (int)(gid / 1792), c = (int)(gid % 1792);
    const float pos = (float)(row % SEQ); bf16_t* pr = P + (size_t)row * INW;
    if (c < 1024) {
        const int d = c & 63; const float sc = c < 512 ? C2 : 1.f;
        if (d < 8) { float s, co; sincos_acc(pos * tab.da[d], s, co); const float x1 = bf2f(pr[c]), x2 = bf2f(pr[c + 8]); pr[c] = f2bf((x1 * co - x2 * s) * sc); pr[c + 8] = f2bf((x2 * co + x1 * s) * sc); }
        else if (d >= 16 && c < 512) pr[c] = f2bf(bf2f(pr[c]) * sc);
    } else if (c >= 1536) {
        const int d = (c - 1536) & 31; const float sc = c >= 1664 ? 0.17677669529663687f : 1.f;
        if (d < 16) { float s, co; sincos_acc(pos * tab.rt[d], s, co); const float x1 = bf2f(pr[c]), x2 = bf2f(pr[c + 16]); pr[c] = f2bf((x1 * co - x2 * s) * sc); pr[c + 16] = f2bf((x2 * co + x1 * s) * sc); }
    }
}

__global__ void __launch_bounds__(64) k_attn(const bf16_t* __restrict__ P, bf16_t* __restrict__ O) {
    const int vh = blockIdx.y & 15, b = blockIdx.y >> 4; const int h = vh >> 2, m = (vh >> 1) & 1, half = vh & 1;
    const int t = blockIdx.x * 64 + threadIdx.x; const size_t rb = (size_t)b * SEQ;
    const bf16_t* q = P + (rb + t) * INW + (h * 2 + m) * 64;
    const bf16_t* K = P + rb * INW + 512 + (h * 2 + m) * 64; const bf16_t* V = P + rb * INW + 1024 + h * 128 + half * 64;
    float qv[64], o[64];
#pragma unroll
    for (int d = 0; d < 64; ++d) { qv[d] = bf2f(q[d]); o[d] = 0.f; }
    float mx = -1e30f, l = 0.f; const int tmax = blockIdx.x * 64 + 63;
    for (int j = 0; j <= tmax; ++j) {
        const uint4* kr = (const uint4*)(K + (size_t)j * INW); float s = 0.f;
#pragma unroll
        for (int c = 0; c < 8; ++c) { const uint4 w = kr[c]; const unsigned ww[4] = {w.x, w.y, w.z, w.w};
#pragma unroll
            for (int e = 0; e < 4; ++e) { s += qv[c * 8 + 2 * e] * __uint_as_float(ww[e] << 16); s += qv[c * 8 + 2 * e + 1] * __uint_as_float(ww[e] & 0xffff0000u); } }
        if (j <= t) {
            const float mn = fmaxf(mx, s); const float f = exp2f(mx - mn), p = exp2f(s - mn); mx = mn; l = l * f + p;
            const uint4* vr = (const uint4*)(V + (size_t)j * INW);
#pragma unroll
            for (int c = 0; c < 8; ++c) { const uint4 w = vr[c]; const unsigned ww[4] = {w.x, w.y, w.z, w.w};
#pragma unroll
                for (int e = 0; e < 4; ++e) { o[c * 8 + 2 * e] = o[c * 8 + 2 * e] * f + p * __uint_as_float(ww[e] << 16); o[c * 8 + 2 * e + 1] = o[c * 8 + 2 * e + 1] * f + p * __uint_as_float(ww[e] & 0xffff0000u); } }
        }
    }
    const float rl = 1.f / l; bf16_t* op = O + (rb + t) * D + h * 256 + m * 128 + half * 64;
#pragma unroll
    for (int d = 0; d < 64; ++d) op[d] = f2bf(o[d] * rl);
}

__global__ void __launch_bounds__(256) k_combine(const bf16_t* __restrict__ O, const float* lq1, const float* lk1, const float* lq2, const float* lk2, const float* __restrict__ g, float lam_init, bf16_t* __restrict__ MIX) {
    const int gid = blockIdx.x * 256 + threadIdx.x; const int row = gid >> 2, h = gid & 3;
    float s1 = 0.f, s2 = 0.f;
    for (int i = 0; i < 64; ++i) { s1 += lq1[i] * lk1[i]; s2 += lq2[i] * lk2[i]; }
    const float lam = expf(s1) - expf(s2) + lam_init;
    const bf16_t* o1 = O + (size_t)row * D + h * 256; const bf16_t* o2 = o1 + 128; float ss = 0.f;
    for (int d = 0; d < 128; ++d) { const float v = bf2f(o1[d]) - lam * bf2f(o2[d]); ss += v * v; }
    const float r = 1.0f / sqrtf(ss * (1.f / 128.f) + EPS) * (1.f - lam_init);
    for (int d = 0; d < 128; ++d) { const float v = bf2f(o1[d]) - lam * bf2f(o2[d]); MIX[(size_t)row * D + h * 128 + d] = f2bf(v * r * g[d]); }
}

__global__ void __launch_bounds__(64) k_ret(const bf16_t* __restrict__ P, const float* __restrict__ rg, bf16_t* __restrict__ MIX) {
    const int h = blockIdx.y & 3, b = blockIdx.y >> 2; const int t = blockIdx.x * 64 + threadIdx.x; const size_t rb = (size_t)b * SEQ;
    const bf16_t* q = P + (rb + t) * INW + 1536 + h * 32; const bf16_t* K = P + rb * INW + 1664 + h * 32; const bf16_t* V = P + rb * INW + 1792 + h * 64;
    float qv[32], o[64];
#pragma unroll
    for (int d = 0; d < 32; ++d) qv[d] = bf2f(q[d]);
#pragma unroll
    for (int d = 0; d < 64; ++d) o[d] = 0.f;
    const float l2g = log2f(1.0f - exp2f(-5.0f - (float)h)); const int tmax = blockIdx.x * 64 + 63;
    for (int j = 0; j <= tmax; ++j) {
        const uint4* kr = (const uint4*)(K + (size_t)j * INW); float s = 0.f;
#pragma unroll
        for (int c = 0; c < 4; ++c) { const uint4 w = kr[c]; const unsigned ww[4] = {w.x, w.y, w.z, w.w};
#pragma unroll
            for (int e = 0; e < 4; ++e) { s += qv[c * 8 + 2 * e] * __uint_as_float(ww[e] << 16); s += qv[c * 8 + 2 * e + 1] * __uint_as_float(ww[e] & 0xffff0000u); } }
        if (j <= t) {
            const float p = s * exp2f((float)(t - j) * l2g);
            const uint4* vr = (const uint4*)(V + (size_t)j * INW);
#pragma unroll
            for (int c = 0; c < 8; ++c) { const uint4 w = vr[c]; const unsigned ww[4] = {w.x, w.y, w.z, w.w};
#pragma unroll
                for (int e = 0; e < 4; ++e) { o[c * 8 + 2 * e] += p * __uint_as_float(ww[e] << 16); o[c * 8 + 2 * e + 1] += p * __uint_as_float(ww[e] & 0xffff0000u); } }
        }
    }
    float mu = 0.f;
#pragma unroll
    for (int d = 0; d < 64; ++d) mu += o[d];
    mu *= (1.f / 64.f); float var = 0.f;
#pragma unroll
    for (int d = 0; d < 64; ++d) { o[d] -= mu; var += o[d] * o[d]; }
    const float r = 1.0f / sqrtf(var * (1.f / 64.f) + EPS);
    const bf16_t* gp = P + (rb + t) * INW + 2048 + h * 64; bf16_t* mp = MIX + (rb + t) * D + 512 + h * 64;
#pragma unroll
    for (int d = 0; d < 64; ++d) { const float gv = bf2f(gp[d]); const float sg = gv / (1.f + expf(-gv)); mp[d] = f2bf(sg * (o[d] * r * rg[h * 64 + d])); }
}

__global__ void __launch_bounds__(256) k_pool(const bf16_t* __restrict__ P, const float* __restrict__ pw, const float* __restrict__ ps, bf16_t* __restrict__ MIX) {
    __shared__ float pooled[256];
    const int row = blockIdx.x, t = row % SEQ, g = threadIdx.x >> 6, p = threadIdx.x & 63; const int w = 2 << g;
    const bf16_t* up = P + (size_t)row * INW + 2304 + threadIdx.x; float s = 0.f; const int n = t + 1 < w ? t + 1 : w;
    for (int i = 0; i < n; ++i) s += bf2f(*(up - (size_t)i * INW));
    pooled[threadIdx.x] = s / (float)n - bf2f(*up);
    __syncthreads();
    float y = 0.f;
    for (int k = 0; k < 64; ++k) y += pooled[g * 64 + k] * pw[(g * 64 + k) * 64 + p];
    MIX[(size_t)row * D + 768 + threadIdx.x] = f2bf(y * ps[threadIdx.x]);
}

__global__ void __launch_bounds__(256) k_convgate(const bf16_t* __restrict__ U, int r0, const float* __restrict__ cw, const float* __restrict__ cb, bf16_t* __restrict__ HID) {
    const size_t gid = (size_t)blockIdx.x * 256 + threadIdx.x; const int tr = (int)(gid / FF), f = (int)(gid % FF); const int t = r0 + tr, ts = t % SEQ;
    float gt = cb[f], vl = cb[FF + f];
#pragma unroll
    for (int j = 0; j < 3; ++j) { const int back = 2 - j; if (ts - back >= 0) { const bf16_t* ur = U + (size_t)(tr + 2 - back) * UPW; gt += cw[j * UPW + f] * bf2f(ur[f]); vl += cw[j * UPW + FF + f] * bf2f(ur[FF + f]); } }
    const float z = 0.7978845608028654f * (gt + 0.044715f * gt * gt * gt); const float ge = 0.5f * gt * (1.f + tanhf(z));
    HID[(size_t)t * FF + f] = f2bf(ge * vl);
}

extern "C" void kernel_launch(void* const* d_in, const int* in_sizes, int n_in, void* d_out, int out_size, void* d_ws, size_t ws_size, hipStream_t stream) {
    const float* x = (const float*)d_in[0]; const float* g_mix_pre = (const float*)d_in[1]; const float* g_mix_post = (const float*)d_in[2]; const float* w_in = (const float*)d_in[3];
    const float* lq1 = (const float*)d_in[4]; const float* lk1 = (const float*)d_in[5]; const float* lq2 = (const float*)d_in[6]; const float* lk2 = (const float*)d_in[7];
    const float* subln = (const float*)d_in[8]; const float* retn = (const float*)d_in[9]; const float* pool_w = (const float*)d_in[10]; const float* pool_s = (const float*)d_in[11];
    const float* w_out = (const float*)d_in[12]; const float* g_mlp_pre = (const float*)d_in[13]; const float* g_mlp_post = (const float*)d_in[14]; const float* w_up = (const float*)d_in[15];
    const float* conv_w = (const float*)d_in[16]; const float* conv_b = (const float*)d_in[17]; const float* w_down = (const float*)d_in[18];
    float* X = (float*)d_out; unsigned char* ws = (unsigned char*)d_ws;
    bf16_t* XN = (bf16_t*)(ws); bf16_t* PROJ = (bf16_t*)(ws + 32 * MiB); bf16_t* OB = (bf16_t*)(ws + 112 * MiB); bf16_t* MIX = (bf16_t*)(ws + 144 * MiB);
    bf16_t* Y = (bf16_t*)(ws + 176 * MiB); bf16_t* HID = (bf16_t*)(ws + 32 * MiB); bf16_t* UCH = (bf16_t*)(ws + 120 * MiB);
    RotTab tab{};
    for (int i = 0; i < 8; ++i) tab.da[i] = powf(500000.0f, -(float)(2 * i) / 16.0f);
    for (int i = 0; i < 16; ++i) tab.rt[i] = powf(10000.0f, -(float)(2 * i) / 32.0f);
    const float* Xcur = x;
    for (int l = 0; l < DEPTH; ++l) {
        const float lam_init = 0.8f - 0.6f * expf(-0.3f * (float)l);
        k_rmsnorm<<<M / 4, 256, 0, stream>>>(Xcur, g_mix_pre + l * D, XN);
        k_gemm<<<dim3(INW / 64, M / 64), 256, 0, stream>>>(XN, D, w_in + (size_t)l * D * INW, INW, PROJ, INW, M, D);
        k_rotary<<<(unsigned)((size_t)M * 1792 / 256), 256, 0, stream>>>(PROJ, tab);
        k_attn<<<dim3(SEQ / 64, BATCH * 16), 64, 0, stream>>>(PROJ, OB);
        k_combine<<<M * 4 / 256, 256, 0, stream>>>(OB, lq1 + l * 64, lk1 + l * 64, lq2 + l * 64, lk2 + l * 64, subln + l * 128, lam_init, MIX);
        k_ret<<<dim3(SEQ / 64, BATCH * 4), 64, 0, stream>>>(PROJ, retn + l * 256, MIX);
        k_pool<<<M, 256, 0, stream>>>(PROJ, pool_w + (size_t)l * 4 * 64 * 64, pool_s + l * 256, MIX);
        k_gemm<<<dim3(D / 64, M / 64), 256, 0, stream>>>(MIX, D, w_out + (size_t)l * D * D, D, Y, D, M, D);
        k_postnorm<<<M / 4, 256, 0, stream>>>(Y, g_mix_post + l * D, Xcur, X);
        Xcur = X;
        k_rmsnorm<<<M / 4, 256, 0, stream>>>(X, g_mlp_pre + l * D, XN);
        const int R = 4096;
        for (int r0 = 0; r0 < M; r0 += R) {
            const int s0 = (r0 % SEQ == 0) ? r0 : r0 - 2; const int rows = r0 + R - s0;
            k_gemm<<<dim3(UPW / 64, (rows + 63) / 64), 256, 0, stream>>>(XN + (size_t)s0 * D, D, w_up + (size_t)l * D * UPW, UPW, UCH + (size_t)(s0 - r0 + 2) * UPW, UPW, rows, D);
            k_convgate<<<(unsigned)((size_t)R * FF / 256), 256, 0, stream>>>(UCH, r0, conv_w + (size_t)l * 3 * UPW, conv_b + (size_t)l * UPW, HID);
        }
        k_gemm<<<dim3(D / 64, M / 64), 256, 0, stream>>>(HID, FF, w_down + (size_t)l * FF * D, D, Y, D, M, FF);
        k_postnorm<<<M / 4, 256, 0, stream>>>(Y, g_mlp_post + l * D, X, X);
    }
}
```
